# Optimizing an MI355X kernel written in HIP

```python
import jax, jax.numpy as jnp
from jax import lax
import numpy as np

D_MODEL = 1024
BATCH = 8
SEQ = 2048
DEPTH = 1
DEC_BATCH = 128
DEC_SEQ = 8
PAST_LEN = 16384
PAGE_SIZE = 128

N_META = 16
D_SCONV = D_MODEL // 2
SCONV_GROUPS = 8
SCONV_WIDTH = 3
SSM_HEAD_DIM = 64
SSM_HEADS = D_MODEL // SSM_HEAD_DIM
D_SSM = SSM_HEADS * SSM_HEAD_DIM
SSM_GROUPS = 2
HEADS_PER_GROUP = SSM_HEADS // SSM_GROUPS
SSM_STATE = 128
SSM_CONV_WIDTH = 4
SSD_CHUNK = 128
D_XBC = D_SSM + 2 * SSM_GROUPS * SSM_STATE
D_MIX = D_SCONV + D_SSM
D_IN = 3 * D_SCONV + D_SSM + D_XBC + SSM_HEADS
D_FF = -(-8 * D_MODEL // (3 * 256)) * 256
EPS = 1e-6

kernel_name = "hymba_sconv_ssd_decoder_step"


def rmsnorm(x, w):
    xf = x.astype(jnp.float32)
    y = xf * lax.rsqrt(jnp.mean(xf * xf, axis=-1, keepdims=True) + EPS) * w.astype(jnp.float32)
    return y.astype(x.dtype)


def group_rmsnorm(x, w, groups, out_dtype):
    shp = x.shape
    xf = x.astype(jnp.float32).reshape(shp[:-1] + (groups, shp[-1] // groups))
    xf = xf * lax.rsqrt(jnp.mean(xf * xf, axis=-1, keepdims=True) + EPS)
    return (xf.reshape(shp) * w.astype(jnp.float32)).astype(out_dtype)


def causal_dwconv(u, buf, w):
    full = jnp.concatenate([buf.astype(u.dtype), u], axis=1)
    L = u.shape[1]
    K = w.shape[0]
    out = full[:, 0:L] * w[0]
    for i in range(1, K):
        out = out + full[:, i:i + L] * w[i]
    return out, full[:, full.shape[1] - (K - 1):]


def ssd_chunked(x, dt, A, B, C, s0, chunk):
    b, L = x.shape[:2]
    nc = L // chunk
    x = x.reshape((b, nc, chunk) + x.shape[2:])
    dt = dt.reshape((b, nc, chunk) + dt.shape[2:])
    B = B.reshape((b, nc, chunk) + B.shape[2:])
    C = C.reshape((b, nc, chunk) + C.shape[2:])
    a_cum = jnp.cumsum(dt * A, axis=2)
    xdt = x * dt[..., None]
    seg = a_cum[:, :, :, None] - a_cum[:, :, None, :]
    causal = (jnp.arange(chunk)[:, None] >= jnp.arange(chunk)[None, :])[None, None, :, :, None, None]
    decay = jnp.exp(jnp.where(causal, seg, -jnp.inf))
    cb = jnp.einsum('bclgn,bcsgn->bclsg', C, B)
    y_diag = jnp.einsum('bclsg,bclsge,bcsgep->bclgep', cb, decay, xdt)
    decay_end = jnp.exp(a_cum[:, :, -1:] - a_cum)
    chunk_states = jnp.einsum('bclgn,bclge,bclgep->bcgepn', B, decay_end, xdt)
    chunk_decay = jnp.exp(a_cum[:, :, -1])

    def step(s, inp):
        dec, st = inp
        return dec[..., None, None] * s + st, s

    s_final, s_prev = lax.scan(step, s0, (jnp.moveaxis(chunk_decay, 1, 0),
                                          jnp.moveaxis(chunk_states.astype(jnp.float32), 1, 0)))
    s_prev = jnp.moveaxis(s_prev, 0, 1)
    y_off = jnp.einsum('bclgn,bcgepn,bclge->bclgep', C, s_prev, jnp.exp(a_cum))
    y = (y_diag + y_off).reshape((b, L) + x.shape[3:])
    return y, s_final


def hybrid_layer(h, buf_sc, buf_xbc, s0, segments,
                 norm_mix_pre, norm_mix_post, w_in, sconv_w, sconv_norm,
                 ssm_conv_w, ssm_conv_b, dt_bias, A_log, D_skip, ssm_norm, w_out,
                 norm_ffn_pre, norm_ffn_post, w_gate, w_up, w_down):
    b, L = h.shape[:2]
    hn = rmsnorm(h, norm_mix_pre)
    proj = hn @ w_in
    o1 = D_SCONV; o2 = 2 * D_SCONV; o3 = 3 * D_SCONV
    o4 = o3 + D_SSM; o5 = o4 + D_XBC
    gate_b = proj[..., :o1]
    gate_c = proj[..., o1:o2]
    hv = proj[..., o2:o3]
    z = proj[..., o3:o4]
    xbc = proj[..., o4:o5]
    dt_raw = proj[..., o5:]
    u = gate_c * hv
    conv_u, new_buf_sc = causal_dwconv(u, buf_sc, sconv_w)
    ya = group_rmsnorm(gate_b * conv_u, sconv_norm, SCONV_GROUPS, h.dtype)
    xbc_c, new_buf_xbc = causal_dwconv(xbc, buf_xbc, ssm_conv_w)
    xbc_c = jax.nn.silu(xbc_c + ssm_conv_b)
    xs = xbc_c[..., :D_SSM].reshape(b, L, SSM_GROUPS, HEADS_PER_GROUP, SSM_HEAD_DIM)
    Bm = xbc_c[..., D_SSM:D_SSM + SSM_GROUPS * SSM_STATE].reshape(b, L, SSM_GROUPS, SSM_STATE)
    Cm = xbc_c[..., D_SSM + SSM_GROUPS * SSM_STATE:].reshape(b, L, SSM_GROUPS, SSM_STATE)
    dt = jax.nn.softplus(dt_raw.astype(jnp.float32) + dt_bias.astype(jnp.float32))
    dt = dt.reshape(b, L, SSM_GROUPS, HEADS_PER_GROUP)
    A = -jnp.exp(A_log.astype(jnp.float32)).reshape(SSM_GROUPS, HEADS_PER_GROUP)
    s = s0.astype(jnp.float32)
    ys = []
    start = 0
    for length, chunk in segments:
        y_seg, s = ssd_chunked(xs[:, start:start + length], dt[:, start:start + length], A,
                               Bm[:, start:start + length], Cm[:, start:start + length], s, chunk)
        ys.append(y_seg)
        start += length
    y = jnp.concatenate(ys, axis=1) if len(ys) > 1 else ys[0]
    y = y + D_skip.astype(jnp.float32).reshape(SSM_GROUPS, HEADS_PER_GROUP)[:, :, None] * xs
    y = y.reshape(b, L, D_SSM) * jax.nn.silu(z.astype(jnp.float32))
    yb = group_rmsnorm(y, ssm_norm, SSM_GROUPS, h.dtype)
    mix = jnp.concatenate([ya, yb], axis=-1) @ w_out
    h = h + rmsnorm(mix, norm_mix_post)
    fn = rmsnorm(h, norm_ffn_pre)
    f = (jax.nn.silu(fn @ w_gate) * (fn @ w_up)) @ w_down
    h = h + rmsnorm(f, norm_ffn_post)
    return h, new_buf_sc, new_buf_xbc, s


def setup_inputs(seed: int = 0) -> dict:
    key = jax.random.key(seed)
    ks = jax.random.split(key, 24)
    f32 = jnp.float32
    n = lambda k, shp, s: jax.random.normal(k, shp, f32) * s
    gain = lambda k, shp: 1.0 + 0.05 * jax.random.normal(k, shp, f32)
    dt0 = jnp.exp(jax.random.uniform(ks[12], (DEPTH, SSM_HEADS), f32, np.log(1e-3), np.log(1e-1)))
    return {
        "x_prompt": n(ks[0], (BATCH, SEQ, D_MODEL), 1.0),
        "x_sample": n(ks[1], (DEC_BATCH, DEC_SEQ, D_MODEL), 1.0),
        "state_sconv": n(ks[2], (DEPTH, DEC_BATCH, SCONV_WIDTH - 1, D_SCONV), 1.0),
        "state_ssm_conv": n(ks[3], (DEPTH, DEC_BATCH, SSM_CONV_WIDTH - 1, D_XBC), 1.0),
        "state_ssm": n(ks[4], (DEPTH, DEC_BATCH, SSM_GROUPS, HEADS_PER_GROUP, SSM_HEAD_DIM, SSM_STATE), 0.5),
        "meta_tokens": n(ks[5], (N_META, D_MODEL), 1.0),
        "norm_mix_pre": gain(ks[6], (DEPTH, D_MODEL)),
        "norm_mix_post": gain(ks[7], (DEPTH, D_MODEL)),
        "w_in": n(ks[8], (DEPTH, D_MODEL, D_IN), D_MODEL ** -0.5),
        "sconv_w": n(ks[9], (DEPTH, SCONV_WIDTH, D_SCONV), SCONV_WIDTH ** -0.5),
        "sconv_norm": gain(ks[10], (DEPTH, D_SCONV)),
        "ssm_conv_w": n(ks[11], (DEPTH, SSM_CONV_WIDTH, D_XBC), SSM_CONV_WIDTH ** -0.5),
        "ssm_conv_b": n(ks[13], (DEPTH, D_XBC), 0.01),
        "dt_bias": dt0 + jnp.log(-jnp.expm1(-dt0)),
        "A_log": jnp.log(jax.random.uniform(ks[14], (DEPTH, SSM_HEADS), f32, 1.0, 16.0)),
        "D_skip": gain(ks[15], (DEPTH, SSM_HEADS)),
        "ssm_norm": gain(ks[16], (DEPTH, D_SSM)),
        "w_out": n(ks[17], (DEPTH, D_MIX, D_MODEL), D_MIX ** -0.5),
        "norm_ffn_pre": gain(ks[18], (DEPTH, D_MODEL)),
        "norm_ffn_post": gain(ks[19], (DEPTH, D_MODEL)),
        "w_gate": n(ks[20], (DEPTH, D_MODEL, D_FF), D_MODEL ** -0.5),
        "w_up": n(ks[21], (DEPTH, D_MODEL, D_FF), D_MODEL ** -0.5),
        "w_down": n(ks[22], (DEPTH, D_FF, D_MODEL), D_FF ** -0.5),
    }


def reference(x_prompt, x_sample, state_sconv, state_ssm_conv, state_ssm, meta_tokens,
              norm_mix_pre, norm_mix_post, w_in, sconv_w, sconv_norm, ssm_conv_w, ssm_conv_b,
              dt_bias, A_log, D_skip, ssm_norm, w_out, norm_ffn_pre, norm_ffn_post,
              w_gate, w_up, w_down):
    bp, seq = x_prompt.shape[:2]
    bs, dseq = x_sample.shape[:2]
    meta = jnp.broadcast_to(meta_tokens[None].astype(x_prompt.dtype), (bp, N_META, D_MODEL))
    hp = jnp.concatenate([meta, x_prompt], axis=1)
    hs = x_sample
    seg_p = ((N_META, N_META), (seq, SSD_CHUNK))
    seg_s = ((dseq, dseq),)
    p_sc, p_xbc, p_ssm, s_sc, s_xbc, s_ssm = [], [], [], [], [], []
    for l in range(DEPTH):
        lw = (norm_mix_pre[l], norm_mix_post[l], w_in[l], sconv_w[l], sconv_norm[l],
              ssm_conv_w[l], ssm_conv_b[l], dt_bias[l], A_log[l], D_skip[l], ssm_norm[l], w_out[l],
              norm_ffn_pre[l], norm_ffn_post[l], w_gate[l], w_up[l], w_down[l])
        hp, b1, b2, st = hybrid_layer(
            hp, jnp.zeros((bp, SCONV_WIDTH - 1, D_SCONV), hp.dtype),
            jnp.zeros((bp, SSM_CONV_WIDTH - 1, D_XBC), hp.dtype),
            jnp.zeros((bp, SSM_GROUPS, HEADS_PER_GROUP, SSM_HEAD_DIM, SSM_STATE), jnp.float32),
            seg_p, *lw)
        p_sc.append(b1); p_xbc.append(b2); p_ssm.append(st)
        hs, b1, b2, st = hybrid_layer(hs, state_sconv[l], state_ssm_conv[l], state_ssm[l], seg_s, *lw)
        s_sc.append(b1); s_xbc.append(b2); s_ssm.append(st)
    y_prompt = hp[:, N_META:]
    y_sample = hs
    return (y_prompt, y_sample, jnp.stack(p_sc), jnp.stack(p_xbc), jnp.stack(p_ssm),
            jnp.stack(s_sc), jnp.stack(s_xbc), jnp.stack(s_ssm))
```

```cpp
#include <hip/hip_runtime.h>
#include <cstdio>
#include <cstdint>
#ifndef MK_SPLIT
#define MK_SPLIT 0
#endif
namespace pg8 {
#define PG8_LAS __attribute__((address_space(3)))
typedef unsigned short bf16_t;
typedef short bf16x8 __attribute__((ext_vector_type(8)));
typedef float f32x4 __attribute__((ext_vector_type(4)));
typedef unsigned u32x4 __attribute__((ext_vector_type(4)));
constexpr int BM = 256, BK = 64, HALF = 128, HTB = HALF * BK * 2  , STAGE_BYTES = 8 * HTB, NXCD = 8, WGM = 8;

__host__ __device__ __forceinline__ int lds_byte(int r, int c) { const int st = (r >> 4) * 2 + (c >> 5), rr = r & 15, cc = c & 31, ob = rr * 64 + cc * 2; return st * 1024 + (ob ^ (((ob >> 9) & 1) << 5)); }
__host__ __device__ __forceinline__ void stage_rc(int b, int& R, int& C) { const int st = b / 1024, sb = b % 1024, swz = sb ^ (((sb >> 9) & 1) << 5); R = (st >> 1) * 16 + swz / 64; C = (st & 1) * 32 + (swz % 64) / 2; }
__host__ __device__ __forceinline__ int perm32(int rho) { const int n = rho >> 4, i = rho & 15; return 8 * (i >> 2) + 4 * n + (i & 3); }

struct Unit { int pm, pn; };
struct Gemm { const bf16_t* A; const bf16_t* Bt; int M, N, K; };

struct StaticOrder {
    int nM, nN, nwg, G, c;
    __host__ __device__ void init(int M, int N, int G_, int c_) { nM = M / BM; nN = N / BM; nwg = nM * nN; G = G_; c = c_; }
    __host__ __device__ bool next(int i, Unit& u) const {
        const long L = (long)i * G + c; if (L >= nwg) return false;
        int wgid = (int)L; { const int q = nwg / NXCD, r = nwg % NXCD, xcd = wgid % NXCD, off = wgid / NXCD; wgid = (xcd < r ? xcd * (q + 1) : r * (q + 1) + (xcd - r) * q) + off; }
        const int nig = WGM * nN, gid = wgid / nig, fm = gid * WGM, gsz = (nM - fm) < WGM ? (nM - fm) : WGM;
        u.pm = fm + ((wgid % nig) % gsz); u.pn = (wgid % nig) / gsz; return true;
    }
    __device__ __forceinline__ void a_ready(const Unit&) const {}
    __device__ __forceinline__ void done(const Unit&) const {}
};

__device__ __forceinline__ unsigned cvt_pk_bf16(float lo, float hi) { unsigned r; asm volatile("v_cvt_pk_bf16_f32 %0, %1, %2" : "=v"(r) : "v"(lo), "v"(hi)); return r; }
typedef float f32x2 __attribute__((ext_vector_type(2)));
typedef unsigned u32x2v __attribute__((ext_vector_type(2)));
__device__ __forceinline__ float fast_silu(float x) { return x * __builtin_amdgcn_rcpf(1.0f + __builtin_amdgcn_exp2f(-1.4426950408889634f * x)); }

struct EpiF32 {
    static constexpr bool PERM = false, AFTER_DRAIN = false;
    float* C; int ldc;
    __device__ __forceinline__ void operator()(const f32x4 (&acc)[2][2][4][2], const Unit& u, int wr, int wc, int fr, int fq) const {
        const int row0 = u.pm * BM + wr * 64 + fr, col0 = u.pn * BM + wc * 32 + 4 * fq;
#pragma unroll
        for (int ai = 0; ai < 2; ++ai)
#pragma unroll
            for (int m = 0; m < 4; ++m) { float* rowp = C + (size_t)(row0 + ai * HALF + m * 16) * ldc + col0;
#pragma unroll
                for (int bj = 0; bj < 2; ++bj)
#pragma unroll
                    for (int n = 0; n < 2; ++n) *(f32x4*)(rowp + bj * HALF + n * 16) = acc[ai][bj][m][n]; }
    }
};
struct EpiProj {
    static constexpr bool PERM = true, AFTER_DRAIN = false;
    bf16_t* P; float* DT; int ldp;
    __device__ __forceinline__ void operator()(const f32x4 (&acc)[2][2][4][2], const Unit& u, int wr, int wc, int fr, int fq) const {
        const int row0 = u.pm * BM + wr * 64 + fr; const int pn = u.pn;
        if (pn == 16) {
            if (wc == 0 && fq < 2) {
#pragma unroll
                for (int ai = 0; ai < 2; ++ai)
#pragma unroll
                    for (int m = 0; m < 4; ++m) { float* d = DT + (size_t)(row0 + ai * HALF + m * 16) * 16 + 8 * fq; *(f32x4*)d = acc[ai][0][m][0]; *(f32x4*)(d + 4) = acc[ai][0][m][1]; }
            }
        } else if (pn >= 2 && pn <= 5) {
            const int col0 = 512 + 128 * (pn - 2) + wc * 32 + 8 * fq;
#pragma unroll
            for (int ai = 0; ai < 2; ++ai)
#pragma unroll
                for (int m = 0; m < 4; ++m) { bf16_t* rowp = P + (size_t)(row0 + ai * HALF + m * 16) * ldp + col0;
                    const f32x4 v0 = acc[ai][0][m][0] * acc[ai][1][m][0], v1 = acc[ai][0][m][1] * acc[ai][1][m][1];
                    u32x4 w; w.x = cvt_pk_bf16(v0[0], v0[1]); w.y = cvt_pk_bf16(v0[2], v0[3]); w.z = cvt_pk_bf16(v1[0], v1[1]); w.w = cvt_pk_bf16(v1[2], v1[3]);
                    *(u32x4*)rowp = w; }
        } else {
            const int cb = pn < 2 ? 256 * pn : (pn < 10 ? 1024 + 256 * (pn - 6) : 2048 + 256 * (pn - 10));
            const int col0 = cb + wc * 32 + 8 * fq;
#pragma unroll
            for (int ai = 0; ai < 2; ++ai)
#pragma unroll
                for (int m = 0; m < 4; ++m) { bf16_t* rowp = P + (size_t)(row0 + ai * HALF + m * 16) * ldp + col0;
#pragma unroll
                    for (int bj = 0; bj < 2; ++bj) { const f32x4 v0 = acc[ai][bj][m][0], v1 = acc[ai][bj][m][1];
                        u32x4 w; w.x = cvt_pk_bf16(v0[0], v0[1]); w.y = cvt_pk_bf16(v0[2], v0[3]); w.z = cvt_pk_bf16(v1[0], v1[1]); w.w = cvt_pk_bf16(v1[2], v1[3]);
                        *(u32x4*)(rowp + bj * HALF) = w; } }
        }
    }
};
struct EpiSwiGLU {
    static constexpr bool PERM = true, AFTER_DRAIN = false;
    bf16_t* O; int ldo;
    __device__ __forceinline__ void operator()(const f32x4 (&acc)[2][2][4][2], const Unit& u, int wr, int wc, int fr, int fq) const {
        const int row0 = u.pm * BM + wr * 64 + fr; const int col0 = 128 * u.pn + wc * 32 + 8 * fq;
#pragma unroll
        for (int ai = 0; ai < 2; ++ai)
#pragma unroll
            for (int m = 0; m < 4; ++m) { bf16_t* rowp = O + (size_t)(row0 + ai * HALF + m * 16) * ldo + col0;
                const f32x4 g0 = acc[ai][0][m][0], g1 = acc[ai][0][m][1], u0 = acc[ai][1][m][0], u1 = acc[ai][1][m][1];
                f32x4 v0, v1;
#pragma unroll
                for (int e = 0; e < 4; ++e) { v0[e] = fast_silu(g0[e]) * u0[e]; v1[e] = fast_silu(g1[e]) * u1[e]; }
                u32x4 w; w.x = cvt_pk_bf16(v0[0], v0[1]); w.y = cvt_pk_bf16(v0[2], v0[3]); w.z = cvt_pk_bf16(v1[0], v1[1]); w.w = cvt_pk_bf16(v1[2], v1[3]);
                *(u32x4*)rowp = w; }
    }
};

template <class Epi, class Sched, bool ALIGN_EPI = false, bool SP2 = false>
__device__ __forceinline__ void gemm_phase(PG8_LAS unsigned char* lds, const Gemm g, const Sched& S, const Epi& E) {
    const int tid = threadIdx.x, wid = __builtin_amdgcn_readfirstlane(tid >> 6), lane = tid & 63, wr = wid >> 2, wc = wid & 3, fr = lane & 15, fq = lane >> 4;
    const int K = g.K, nt = K / BK;
    unsigned voffA[2], voffB[2];
#pragma unroll
    for (int i = 0; i < 2; ++i) { int R, C; stage_rc(tid * 16 + i * 8192, R, C); const int Rb = Epi::PERM ? ((R & ~31) + perm32(R & 31)) : R;
        voffA[i] = (unsigned)(R * K + C) * 2u; voffB[i] = (unsigned)(Rb * K + C) * 2u; }
    const size_t kstep = (size_t)(BK * 2);
    const size_t hstep = (size_t)HALF * K * 2;
    const size_t tstep = 2 * hstep;
    const unsigned ldsw = (unsigned)wid * 1024u;
    const int aoff = lds_byte(wr * 64 + fr, fq * 8), boff = lds_byte(wc * 32 + fr, fq * 8);
#define PG8_SA(b, h) (((b) * 2 + (h)) * HTB)
#define PG8_SB(b, h) ((4 + (b) * 2 + (h)) * HTB)
#define PG8_STAGE(bufoff, gbase, voff) do { _Pragma("unroll") for (int _i = 0; _i < 2; ++_i) \
        __builtin_amdgcn_global_load_lds((const unsigned*)((const char*)(gbase) + (voff)[_i]), (PG8_LAS unsigned*)(lds + (bufoff) + ldsw + _i * 8192), 16, 0, 0); } while (0)
#define PG8_LDA(dst, b, h) do { _Pragma("unroll") for (int m = 0; m < 4; ++m) _Pragma("unroll") for (int k = 0; k < 2; ++k) dst[m][k] = *(const PG8_LAS bf16x8*)(lds + PG8_SA(b, h) + aoff + m * 2048 + k * 1024); } while (0)
#define PG8_LDB(dst, b, h) do { _Pragma("unroll") for (int n = 0; n < 2; ++n) _Pragma("unroll") for (int k = 0; k < 2; ++k) dst[n][k] = *(const PG8_LAS bf16x8*)(lds + PG8_SB(b, h) + boff + n * 2048 + k * 1024); } while (0)
#define PG8_MMA(ai, bj, At, Bt) do { __builtin_amdgcn_s_setprio(1); _Pragma("unroll") for (int m = 0; m < 4; ++m) _Pragma("unroll") for (int n = 0; n < 2; ++n) _Pragma("unroll") for (int k = 0; k < 2; ++k) \
        acc[ai][bj][m][n] = __builtin_amdgcn_mfma_f32_16x16x32_bf16(Bt[n][k], At[m][k], acc[ai][bj][m][n], 0, 0, 0); __builtin_amdgcn_s_setprio(0); } while (0)
#define PG8_WAIT_V(n) asm volatile("s_waitcnt vmcnt(" #n ")" ::: "memory")
#define PG8_WAIT_L(n) asm volatile("s_waitcnt lgkmcnt(" #n ")" ::: "memory")
#define PG8_BAR __builtin_amdgcn_s_barrier()
#define PG8_SCHED __builtin_amdgcn_sched_barrier(0)
    Unit cur, nxt; int ui = 0;
    if (!S.next(0, cur)) return;
    f32x4 acc[2][2][4][2];
#pragma unroll
    for (int a = 0; a < 2; ++a)
#pragma unroll
        for (int b = 0; b < 2; ++b)
#pragma unroll
            for (int m = 0; m < 4; ++m)
#pragma unroll
                for (int n = 0; n < 2; ++n) acc[a][b][m][n] = (f32x4){0.f, 0.f, 0.f, 0.f};
    bf16x8 At[4][2], B0[2][2], B1[2][2];
    const char* cA = (const char*)g.A + (size_t)cur.pm * tstep; const char* cB = (const char*)g.Bt + (size_t)cur.pn * tstep;
    S.a_ready(cur);
    if constexpr (SP2) {
        PG8_STAGE(PG8_SB(0, 0), cB, voffB); PG8_STAGE(PG8_SB(0, 1), cB + hstep, voffB); PG8_STAGE(PG8_SA(0, 0), cA, voffA); PG8_STAGE(PG8_SA(0, 1), cA + hstep, voffA);
        if (wr == 1) PG8_BAR;
        PG8_WAIT_V(2); PG8_BAR;
        PG8_STAGE(PG8_SB(1, 0), cB + kstep, voffB); PG8_STAGE(PG8_SA(1, 0), cA + kstep, voffA); PG8_STAGE(PG8_SB(1, 1), cB + hstep + kstep, voffB);
        PG8_WAIT_V(6); PG8_BAR;
    } else {
        PG8_STAGE(PG8_SB(0, 0), cB, voffB); PG8_STAGE(PG8_SA(0, 0), cA, voffA); PG8_STAGE(PG8_SB(0, 1), cB + hstep, voffB); PG8_STAGE(PG8_SA(0, 1), cA + hstep, voffA);
        if (wr == 1) PG8_BAR;
        PG8_WAIT_V(4); PG8_BAR;
        PG8_STAGE(PG8_SB(1, 0), cB + kstep, voffB); PG8_STAGE(PG8_SA(1, 0), cA + kstep, voffA); PG8_STAGE(PG8_SB(1, 1), cB + hstep + kstep, voffB);
        PG8_WAIT_V(6); PG8_BAR;
    }
    for (;;) {
        const bool has_next = S.next(ui + 1, nxt);
        const char* nA = has_next ? (const char*)g.A + (size_t)nxt.pm * tstep : cA; const char* nB = has_next ? (const char*)g.Bt + (size_t)nxt.pn * tstep : cB;
        for (int t = 0; t < nt; t += 2) {
            const bool last = (t == nt - 2);
            const char* a1 = cA + (size_t)(t + 1) * kstep;
            const char* a2 = last ? nA : cA + (size_t)(t + 2) * kstep; const char* b2 = last ? nB : cB + (size_t)(t + 2) * kstep;
            const char* a3 = a2 + kstep; const char* b3 = b2 + kstep;
            if (last && has_next) S.a_ready(nxt);
            if constexpr (SP2) {
            PG8_LDB(B0, 0, 0); PG8_LDB(B1, 0, 1); PG8_SCHED; PG8_LDA(At, 0, 0); PG8_STAGE(PG8_SA(1, 1), a1 + hstep, voffA);
            PG8_WAIT_V(8); PG8_WAIT_L(0); PG8_BAR; PG8_MMA(0, 0, At, B0); PG8_MMA(0, 1, At, B1); PG8_BAR; PG8_SCHED;
            PG8_LDA(At, 0, 1); PG8_STAGE(PG8_SB(0, 0), b2, voffB); PG8_STAGE(PG8_SB(0, 1), b2 + hstep, voffB); PG8_STAGE(PG8_SA(0, 0), a2, voffA);
            PG8_WAIT_V(8); PG8_WAIT_L(0); PG8_BAR; PG8_MMA(1, 0, At, B0); PG8_MMA(1, 1, At, B1); PG8_BAR; PG8_SCHED;
            PG8_LDB(B0, 1, 0); PG8_LDB(B1, 1, 1); PG8_SCHED; PG8_LDA(At, 1, 0); PG8_STAGE(PG8_SA(0, 1), a2 + hstep, voffA);
            PG8_WAIT_V(8); PG8_WAIT_L(0); PG8_BAR; PG8_MMA(0, 0, At, B0); PG8_MMA(0, 1, At, B1); PG8_BAR; PG8_SCHED;
            PG8_LDA(At, 1, 1); PG8_STAGE(PG8_SB(1, 0), b3, voffB); PG8_STAGE(PG8_SB(1, 1), b3 + hstep, voffB); PG8_STAGE(PG8_SA(1, 0), a3, voffA);
            PG8_WAIT_V(8); PG8_WAIT_L(0); PG8_BAR; PG8_MMA(1, 0, At, B0); PG8_MMA(1, 1, At, B1); PG8_BAR; PG8_SCHED;
            } else {
            PG8_LDB(B0, 0, 0); PG8_SCHED; PG8_LDA(At, 0, 0); PG8_STAGE(PG8_SA(1, 1), a1 + hstep, voffA);
            PG8_WAIT_L(8); PG8_BAR; PG8_WAIT_L(0); PG8_MMA(0, 0, At, B0); PG8_BAR; PG8_SCHED;
            PG8_LDB(B1, 0, 1); PG8_STAGE(PG8_SB(0, 0), b2, voffB);
            PG8_BAR; PG8_WAIT_L(0); PG8_MMA(0, 1, At, B1); PG8_BAR;
            PG8_LDA(At, 0, 1); PG8_STAGE(PG8_SA(0, 0), a2, voffA);
            PG8_BAR; PG8_WAIT_L(0); PG8_MMA(1, 0, At, B0); PG8_BAR; PG8_SCHED;
            PG8_STAGE(PG8_SB(0, 1), b2 + hstep, voffB);
            PG8_WAIT_V(6); PG8_BAR; PG8_MMA(1, 1, At, B1); PG8_BAR;
            PG8_LDB(B0, 1, 0); PG8_SCHED; PG8_LDA(At, 1, 0); PG8_STAGE(PG8_SA(0, 1), a2 + hstep, voffA);
            PG8_WAIT_L(8); PG8_BAR; PG8_WAIT_L(0); PG8_MMA(0, 0, At, B0); PG8_BAR; PG8_SCHED;
            PG8_LDB(B1, 1, 1); PG8_STAGE(PG8_SB(1, 0), b3, voffB);
            PG8_BAR; PG8_WAIT_L(0); PG8_MMA(0, 1, At, B1); PG8_BAR;
            PG8_LDA(At, 1, 1); PG8_STAGE(PG8_SA(1, 0), a3, voffA);
            PG8_BAR; PG8_WAIT_L(0); PG8_MMA(1, 0, At, B0); PG8_BAR; PG8_SCHED;
            PG8_STAGE(PG8_SB(1, 1), b3 + hstep, voffB);
            PG8_WAIT_V(6); PG8_BAR; PG8_MMA(1, 1, At, B1); PG8_BAR;
            }
        }
        if constexpr (ALIGN_EPI) { if (wr == 0) PG8_BAR; }
        if constexpr (!Epi::AFTER_DRAIN) { E(acc, cur, wr, wc, fr, fq); S.done(cur); }
        if (!has_next) break;
#pragma unroll
        for (int a = 0; a < 2; ++a)
#pragma unroll
            for (int b = 0; b < 2; ++b)
#pragma unroll
                for (int m = 0; m < 4; ++m)
#pragma unroll
                    for (int n = 0; n < 2; ++n) acc[a][b][m][n] = (f32x4){0.f, 0.f, 0.f, 0.f};
        cur = nxt; cA = nA; cB = nB; ++ui;
        if constexpr (ALIGN_EPI) { if (wr == 1) PG8_BAR; }
    }
    PG8_WAIT_V(0);
    if constexpr (!ALIGN_EPI) { if (wr == 0) PG8_BAR; }
    PG8_BAR;
    if constexpr (Epi::AFTER_DRAIN) { E.fused(acc, cur, wr, wc, fr, fq, lds, wid, lane); S.done(cur); }
#undef PG8_SA
#undef PG8_SB
#undef PG8_STAGE
#undef PG8_LDA
#undef PG8_LDB
#undef PG8_MMA
#undef PG8_WAIT_V
#undef PG8_WAIT_L
#undef PG8_BAR
#undef PG8_SCHED
}
}
#ifndef PG8_SP2
#define PG8_SP2 true
#endif
#ifndef PG8_ALIGN
#define PG8_ALIGN true
#endif
constexpr int NWAVES = 8;
constexpr int DM = 1024, NBATCH = 8, SEQ = 2048, NMETA = 16, DBATCH = 128, DSEQ = 8;
constexpr int M_PROMPT = NBATCH * SEQ;
constexpr int M_SAMPLE = DBATCH * DSEQ;
constexpr int M_MAIN = M_PROMPT + M_SAMPLE;
constexpr int ROW_META = M_MAIN;
constexpr int M_G1 = 69 * 256;
constexpr int D_XBC = 1536, D_FF = 2816, NHEAD = 16;
constexpr int D_IN = 4112, N_G1 = 4352, LDP = 3584;
constexpr int PC_U = 512, PC_Z = 1024, PC_X = 2048, PC_B = 3072, PC_C = 3328;
constexpr int LDA2 = 1536;
constexpr float EPS = 1e-6f;
constexpr size_t O_SCP = 17825792, O_XCP = 17833984, O_SSP = 17870848, O_SCS = 18919424, O_XCS = 19050496, O_SSS = 19640320, O_END = 36417536;
constexpr size_t MiB = 1u << 20;
constexpr size_t WS_CTL = 0, CTL_ZERO_BYTES = 128 * 1024;
constexpr size_t WS_WIN = 1 * MiB, WS_WOUT = 10 * MiB, WS_WGU = 13 * MiB, WS_WDOWN = 24 * MiB, WS_DT = 30 * MiB;
constexpr size_t WS_XN = 32 * MiB, WS_SPREV = 32 * MiB;
constexpr size_t WS_PROJ = 67 * MiB, WS_MIX = 67 * MiB, WS_ACT = 67 * MiB;
constexpr size_t WS_A2 = 188 * MiB, WS_F = 188 * MiB, WS_END = 256 * MiB;
static_assert(WS_WIN + (size_t)N_G1 * DM * 2 <= WS_WOUT && WS_WOUT + (size_t)DM * 1536 * 2 <= WS_WGU && WS_WGU + (size_t)2 * D_FF * DM * 2 <= WS_WDOWN && WS_WDOWN + (size_t)DM * D_FF * 2 <= WS_DT, "ws map 1");
static_assert(WS_DT + (size_t)M_G1 * 16 * 4 <= WS_XN && WS_XN + (size_t)M_G1 * DM * 2 <= WS_PROJ && WS_PROJ + (size_t)M_G1 * LDP * 2 <= WS_A2 && WS_A2 + (size_t)M_MAIN * LDA2 * 2 <= WS_END, "ws map 2");
static_assert(WS_ACT + (size_t)M_MAIN * D_FF * 2 <= WS_F && WS_F + (size_t)M_MAIN * DM * 4 <= WS_END && WS_SPREV + (size_t)128 * 16 * 64 * 128 * 2 <= WS_PROJ, "ws map 3");
constexpr int CW_TMO = 0, CW_CODE = 1, CW_BAR = 4096;
constexpr int RING_OFF = 0, RING_BYTES = 131072;
constexpr int LDSCTL_OFF = RING_BYTES, MISC_OFF = LDSCTL_OFF + 320, EXTRA_OFF = LDSCTL_OFF + 512;
constexpr int LDS_BYTES = 147456;

#define GAS __attribute__((address_space(1)))
#define LAS __attribute__((address_space(3)))
typedef unsigned short bf16;
typedef unsigned v4u __attribute__((ext_vector_type(4)));
typedef unsigned v2u __attribute__((ext_vector_type(2)));
typedef float f32x4 __attribute__((ext_vector_type(4)));
typedef float f32x2 __attribute__((ext_vector_type(2)));
typedef short bf16x8 __attribute__((ext_vector_type(8)));
typedef short s16x4 __attribute__((ext_vector_type(4)));
typedef GAS unsigned gu32;
#define RLX_AGENT __ATOMIC_RELAXED, __HIP_MEMORY_SCOPE_AGENT
#define LDS_WAIT() asm volatile("s_waitcnt lgkmcnt(0)" ::: "memory")
#define VM_WAIT() asm volatile("s_waitcnt vmcnt(0)" ::: "memory")
__device__ __forceinline__ unsigned pkbf(float lo, float hi) { unsigned r; asm("v_cvt_pk_bf16_f32 %0, %1, %2" : "=v"(r) : "v"(lo), "v"(hi)); return r; }
__device__ __forceinline__ float bflo(unsigned u) { return __uint_as_float(u << 16); }
__device__ __forceinline__ float bfhi(unsigned u) { return __uint_as_float(u & 0xffff0000u); }
__device__ __forceinline__ float silu_f(float x) { return x * __builtin_amdgcn_rcpf(1.0f + __builtin_amdgcn_exp2f(-1.4426950408889634f * x)); }
__device__ __forceinline__ float softplus_f(float x) { return x > 20.f ? x : log1pf(__expf(x)); }
__device__ __forceinline__ float wave_sum(float v) {
#pragma unroll
    for (int o = 1; o < 64; o <<= 1) v += __shfl_xor(v, o);
    return v;
}
__device__ __forceinline__ void unpack8(const v4u w, float (&o)[8]) {
    o[0] = bflo(w.x); o[1] = bfhi(w.x); o[2] = bflo(w.y); o[3] = bfhi(w.y); o[4] = bflo(w.z); o[5] = bfhi(w.z); o[6] = bflo(w.w); o[7] = bfhi(w.w);
}
__device__ __forceinline__ v4u pack8(const float (&o)[8]) { v4u w; w.x = pkbf(o[0], o[1]); w.y = pkbf(o[2], o[3]); w.z = pkbf(o[4], o[5]); w.w = pkbf(o[6], o[7]); return w; }
__device__ __forceinline__ bf16x8 pack8v(const f32x4 a, const f32x4 b) { v4u w; w.x = pkbf(a[0], a[1]); w.y = pkbf(a[2], a[3]); w.z = pkbf(b[0], b[1]); w.w = pkbf(b[2], b[3]); return __builtin_bit_cast(bf16x8, w); }
__device__ __forceinline__ bf16x8 cat4(const s16x4 a, const s16x4 b) { bf16x8 r; r[0] = a[0]; r[1] = a[1]; r[2] = a[2]; r[3] = a[3]; r[4] = b[0]; r[5] = b[1]; r[6] = b[2]; r[7] = b[3]; return r; }
__device__ __forceinline__ unsigned off_b(unsigned row, unsigned ch) { return 256u * row + 16u * (ch ^ (((row & 3) << 2) | ((row >> 2) & 3))); }
__device__ __forceinline__ unsigned row_read_addr_16(unsigned lane, unsigned rb, unsigned s) { return off_b((lane & 15) + 16 * rb, 4 * s + (lane >> 4)); }
__device__ __forceinline__ unsigned tr_read_addr_16(unsigned lane, unsigned c, unsigned ks, unsigned t) {
    const unsigned g = lane >> 4, q = (lane & 15) >> 2, p = lane & 3;
    return off_b(32 * ks + 8 * g + 4 * t + q, 2 * c + (p >> 1)) + 8 * (p & 1);
}
__device__ __forceinline__ unsigned tr_read_addr_perm(unsigned lane, unsigned c, unsigned ks, unsigned t) {
    const unsigned g = lane >> 4, q = (lane & 15) >> 2, p = lane & 3;
    return off_b(32 * ks + 16 * t + 4 * g + q, 2 * c + (p >> 1)) + 8 * (p & 1);
}
__device__ __forceinline__ s16x4 tr_read(LAS unsigned char* p) { return __builtin_amdgcn_ds_read_tr16_b64_v4i16((LAS s16x4*)p); }
#define MFMA16(a, b, c) __builtin_amdgcn_mfma_f32_16x16x32_bf16((a), (b), (c), 0, 0, 0)

#define XB_TMO      128
#define XB_XCNT(j)  (256  + 64 * (j))
#define XB_XSUB(j)  (1280 + 64 * (j))
#define XB_XGEN(j)  (2304 + 64 * (j))
#define XB_TOP      3328
#define XB_TOPGEN   3392
#define XCD_BAR_WORDS 3456
#define XB_SPIN_CAP (1u << 18)

__device__ __forceinline__ unsigned xb_ld(unsigned* p)              { return __hip_atomic_load(p, __ATOMIC_RELAXED, __HIP_MEMORY_SCOPE_AGENT); }
__device__ __forceinline__ unsigned xb_add(unsigned* p, unsigned v) { return __hip_atomic_fetch_add(p, v, __ATOMIC_RELAXED, __HIP_MEMORY_SCOPE_AGENT); }
__device__ __forceinline__ unsigned xb_xcc_id() { return (unsigned)__builtin_amdgcn_s_getreg((3 << 11) | 20) & 0xFu; }
#define XB_SPIN(cond, bar) do { unsigned _sp = 0; while (cond) { __builtin_amdgcn_s_sleep(1); \
    if ((++_sp & 255u) == 0u) { if (xb_ld(&(bar)[XB_TMO])) break; if (_sp > XB_SPIN_CAP) { atomicAdd(&(bar)[XB_TMO], 1u); break; } } } } while (0)

struct XcdBarrier {
    unsigned* bar; unsigned x;
    volatile LAS unsigned* st;
};

__device__ __forceinline__ XcdBarrier xcd_barrier_post(unsigned* bar, volatile LAS unsigned* st) {
    XcdBarrier b; b.bar = bar; b.x = xb_xcc_id(); b.st = st;
    if (threadIdx.x == 0) (void)xb_add(&bar[XB_XCNT(b.x)], 1u);
    return b;
}
__device__ __forceinline__ void xcd_barrier_complete(unsigned* bar, unsigned x, unsigned& nloc, unsigned& nx) {
    const unsigned G = gridDim.x * gridDim.y * gridDim.z;
    unsigned sum, cnt, mine, sp = 0u;
    for (;;) {
        sum = 0u; cnt = 0u; mine = 0u;
#pragma unroll
        for (unsigned j = 0; j < 16; ++j) { const unsigned c = xb_ld(&bar[XB_XCNT(j)]); sum += c; cnt += (c > 0u) ? 1u : 0u; mine = (j == x) ? c : mine; }
        if (sum == G) break;
        __builtin_amdgcn_s_sleep(1);
        if ((++sp & 255u) == 0u) { if (xb_ld(&bar[XB_TMO])) break; if (sp > XB_SPIN_CAP) { atomicAdd(&bar[XB_TMO], 1u); break; } }
    }
    nloc = mine > 0u ? mine : 1u; nx = cnt > 0u ? cnt : 1u;
}

__device__ __forceinline__ void xcd_barrier(const XcdBarrier& b) {
    asm volatile("s_waitcnt vmcnt(0)" ::: "memory");
    __syncthreads();
    if (threadIdx.x == 0) {
        unsigned* bar = b.bar;
        __builtin_amdgcn_s_waitcnt(0);
        unsigned nloc = b.st[0], nx = b.st[1];
        if (nloc == 0u) { xcd_barrier_complete(bar, b.x, nloc, nx); b.st[0] = nloc; b.st[1] = nx; }
        const unsigned old = xb_add(&bar[XB_XSUB(b.x)], 1u);
        const unsigned gen = old / nloc;
        if (old + 1u == (gen + 1u) * nloc) {
            __builtin_amdgcn_fence(__ATOMIC_RELEASE, "agent");
            asm volatile("s_waitcnt vmcnt(0)" ::: "memory");
            const unsigned og = xb_add(&bar[XB_TOP], 1u);
            const unsigned tg = og / nx;
            if (og + 1u == (tg + 1u) * nx) xb_add(&bar[XB_TOPGEN], 1u);
            else XB_SPIN(xb_ld(&bar[XB_TOPGEN]) == tg, bar);
            __builtin_amdgcn_fence(__ATOMIC_ACQUIRE, "agent");
            xb_add(&bar[XB_XGEN(b.x)], 1u);
            asm volatile("s_waitcnt vmcnt(0)" ::: "memory");
        } else {
            XB_SPIN(xb_ld(&bar[XB_XGEN(b.x)]) == gen, bar);
            __builtin_amdgcn_fence(__ATOMIC_ACQUIRE, "agent");
            asm volatile("s_waitcnt vmcnt(0)" ::: "memory");
        }
    }
    __syncthreads();
}
struct Ctx {
    LAS unsigned char* lds;
    gu32* ctl;
    int tid, lane, wave, G;
    const float* in[23]; float* out; unsigned char* ws;
};
#define IN_XP(C)    ((C).in[0])
#define IN_XS(C)    ((C).in[1])
#define IN_SSC(C)   ((C).in[2])
#define IN_SXC(C)   ((C).in[3])
#define IN_SSM(C)   ((C).in[4])
#define IN_META(C)  ((C).in[5])
#define IN_NMPRE(C) ((C).in[6])
#define IN_NMPOST(C) ((C).in[7])
#define IN_WIN(C)   ((C).in[8])
#define IN_SCW(C)   ((C).in[9])
#define IN_SCN(C)   ((C).in[10])
#define IN_CW(C)    ((C).in[11])
#define IN_CB(C)    ((C).in[12])
#define IN_DTB(C)   ((C).in[13])
#define IN_ALOG(C)  ((C).in[14])
#define IN_DSK(C)   ((C).in[15])
#define IN_SSN(C)   ((C).in[16])
#define IN_WOUT(C)  ((C).in[17])
#define IN_NFPRE(C) ((C).in[18])
#define IN_NFPOST(C) ((C).in[19])
#define IN_WG(C)    ((C).in[20])
#define IN_WU(C)    ((C).in[21])
#define IN_WD(C)    ((C).in[22])
#define WS_BF(C, off) ((bf16*)((C).ws + (off)))
#define WS_F32(C, off) ((float*)((C).ws + (off)))

__device__ __forceinline__ void p0_transpose_item(const float* W, int ldw, int src_c0, int nvalid, bf16* WT, int Kd, int dst_r0, int k0, LAS float* scr, int lane) {
    const int col = lane & 31;
#pragma unroll 8
    for (int i = 0; i < 32; ++i) { const int kk = 2 * i + (lane >> 5); scr[kk * 33 + col] = (col < nvalid) ? W[(size_t)(k0 + kk) * ldw + src_c0 + col] : 0.f; }
    LDS_WAIT(); asm volatile("" ::: "memory");
    const int c = lane & 7;
#pragma unroll
    for (int j = 0; j < 4; ++j) { const int n = (lane >> 3) + 8 * j; const LAS float* s = scr + (8 * c) * 33 + n;
        v4u o; o.x = pkbf(s[0 * 33], s[1 * 33]); o.y = pkbf(s[2 * 33], s[3 * 33]); o.z = pkbf(s[4 * 33], s[5 * 33]); o.w = pkbf(s[6 * 33], s[7 * 33]);
        *(v4u*)(WT + (size_t)(dst_r0 + n) * Kd + k0 + 8 * c) = o; }
    LDS_WAIT(); asm volatile("" ::: "memory");
}
__device__ __forceinline__ void rms_row_to_bf16(const float* xrow, const float* wv, bf16* orow, int lane) {
    const f32x4* xr = (const f32x4*)xrow + lane; const f32x4* wr = (const f32x4*)wv + lane;
    f32x4 v[4]; float s = 0.f;
#pragma unroll
    for (int j = 0; j < 4; ++j) { v[j] = xr[64 * j]; s += (v[j].x * v[j].x + v[j].y * v[j].y) + (v[j].z * v[j].z + v[j].w * v[j].w); }
    const float rstd = 1.0f / sqrtf(wave_sum(s) * (1.f / DM) + EPS);
    unsigned long long* o8 = (unsigned long long*)orow + lane;
#pragma unroll
    for (int j = 0; j < 4; ++j) { const f32x4 w = wr[64 * j];
        o8[64 * j] = (unsigned long long)pkbf(v[j].x * rstd * w.x, v[j].y * rstd * w.y) | ((unsigned long long)pkbf(v[j].z * rstd * w.z, v[j].w * rstd * w.w) << 32); }
}
__device__ __forceinline__ const float* h_row_ptr(const Ctx& C, int m) {
    return m < M_PROMPT ? IN_XP(C) + (size_t)m * DM : (m < M_MAIN ? IN_XS(C) + (size_t)(m - M_PROMPT) * DM : IN_META(C) + (size_t)(m - ROW_META) * DM);
}
__device__ __forceinline__ void p0_prologue(const Ctx& C) {
    LAS float* scr = (LAS float*)(C.lds + RING_OFF + C.wave * 16384);
    const int gw = blockIdx.x * NWAVES + C.wave, NGW = C.G * NWAVES;
    constexpr int I_IN = (N_G1 / 32) * (DM / 64), I_OUT = (DM / 32) * (1536 / 64), I_GU = (2 * D_FF / 32) * (DM / 64), I_DN = (DM / 32) * (D_FF / 64);
    constexpr int NITEMS = I_IN + I_OUT + I_GU + I_DN;
    for (int it = gw; it < NITEMS; it += NGW) {
        int r = it;
        if (r < I_IN) { const int nb = r % (N_G1 / 32), kb = r / (N_G1 / 32), d0 = 32 * nb; int src, nv;
            if (d0 < 512) { src = d0; nv = 32; }
            else if (d0 < 1536) { const int blk = (d0 - 512) >> 7, within = (d0 - 512) & 127; src = ((blk & 1) ? 1024 : 512) + 128 * (blk >> 1) + within; nv = 32; }
            else { src = d0; nv = D_IN - d0; nv = nv < 0 ? 0 : (nv > 32 ? 32 : nv); if (nv == 0) src = 0; }
            p0_transpose_item(IN_WIN(C), D_IN, src, nv, WS_BF(C, WS_WIN), DM, d0, 64 * kb, scr, C.lane); continue; }
        r -= I_IN;
        if (r < I_OUT) { const int nb = r % (DM / 32), kb = r / (DM / 32);
            p0_transpose_item(IN_WOUT(C), DM, 32 * nb, 32, WS_BF(C, WS_WOUT), 1536, 32 * nb, 64 * kb, scr, C.lane); continue; }
        r -= I_OUT;
        if (r < I_GU) { const int nb = r % (2 * D_FF / 32), kb = r / (2 * D_FF / 32), d0 = 32 * nb, tile = d0 >> 8, half = (d0 >> 7) & 1, idx = d0 & 127;
            p0_transpose_item(half ? IN_WU(C) : IN_WG(C), D_FF, 128 * tile + idx, 32, WS_BF(C, WS_WGU), DM, d0, 64 * kb, scr, C.lane); continue; }
        r -= I_GU;
        { const int nb = r % (DM / 32), kb = r / (DM / 32);
            p0_transpose_item(IN_WD(C), DM, 32 * nb, 32, WS_BF(C, WS_WDOWN), D_FF, 32 * nb, 64 * kb, scr, C.lane); }
    }
    bf16* XN = WS_BF(C, WS_XN);
    for (int m = gw; m < M_G1; m += NGW) {
        if (m < ROW_META + NMETA) rms_row_to_bf16(h_row_ptr(C, m), IN_NMPRE(C), XN + (size_t)m * DM, C.lane);
        else { v4u z = {0u, 0u, 0u, 0u}; v4u* o = (v4u*)(XN + (size_t)m * DM) + C.lane; o[0] = z; o[64] = z; }
    }
}
__device__ __forceinline__ void norm1_phase(const Ctx& C) {
    const int gw = blockIdx.x * NWAVES + C.wave, NGW = C.G * NWAVES, lane = C.lane;
    const float* MIX = WS_F32(C, WS_MIX); bf16* XN = WS_BF(C, WS_XN);
    for (int m = gw; m < M_MAIN; m += NGW) {
        const f32x4* mr = (const f32x4*)(MIX + (size_t)m * DM) + lane; const f32x4* hr = (const f32x4*)h_row_ptr(C, m) + lane;
        const f32x4* w1 = (const f32x4*)IN_NMPOST(C) + lane; const f32x4* w2 = (const f32x4*)IN_NFPRE(C) + lane;
        f32x4 v[4], h[4]; float s = 0.f;
#pragma unroll
        for (int j = 0; j < 4; ++j) { v[j] = mr[64 * j]; h[j] = hr[64 * j]; s += (v[j].x * v[j].x + v[j].y * v[j].y) + (v[j].z * v[j].z + v[j].w * v[j].w); }
        const float rstd = 1.0f / sqrtf(wave_sum(s) * (1.f / DM) + EPS); float s2 = 0.f;
        f32x4* orow = (f32x4*)(C.out + (size_t)m * DM) + lane;
#pragma unroll
        for (int j = 0; j < 4; ++j) { const f32x4 w = w1[64 * j]; h[j] = h[j] + v[j] * rstd * w; orow[64 * j] = h[j];
            s2 += (h[j].x * h[j].x + h[j].y * h[j].y) + (h[j].z * h[j].z + h[j].w * h[j].w); }
        const float rstd2 = 1.0f / sqrtf(wave_sum(s2) * (1.f / DM) + EPS);
        unsigned long long* o8 = (unsigned long long*)(XN + (size_t)m * DM) + lane;
#pragma unroll
        for (int j = 0; j < 4; ++j) { const f32x4 w = w2[64 * j];
            o8[64 * j] = (unsigned long long)pkbf(h[j].x * rstd2 * w.x, h[j].y * rstd2 * w.y) | ((unsigned long long)pkbf(h[j].z * rstd2 * w.z, h[j].w * rstd2 * w.w) << 32); }
    }
}
__device__ __forceinline__ void norm2_phase(const Ctx& C) {
    const int gw = blockIdx.x * NWAVES + C.wave, NGW = C.G * NWAVES, lane = C.lane;
    const float* Fb = WS_F32(C, WS_F);
    for (int m = gw; m < M_MAIN; m += NGW) {
        const f32x4* fr = (const f32x4*)(Fb + (size_t)m * DM) + lane; f32x4* orow = (f32x4*)(C.out + (size_t)m * DM) + lane;
        const f32x4* w1 = (const f32x4*)IN_NFPOST(C) + lane;
        f32x4 v[4], h[4]; float s = 0.f;
#pragma unroll
        for (int j = 0; j < 4; ++j) { v[j] = fr[64 * j]; h[j] = orow[64 * j]; s += (v[j].x * v[j].x + v[j].y * v[j].y) + (v[j].z * v[j].z + v[j].w * v[j].w); }
        const float rstd = 1.0f / sqrtf(wave_sum(s) * (1.f / DM) + EPS);
#pragma unroll
        for (int j = 0; j < 4; ++j) { const f32x4 w = w1[64 * j]; orow[64 * j] = h[j] + v[j] * rstd * w; }
    }
}
__device__ __forceinline__ int prow(int b, int pos) { return pos < NMETA ? ROW_META + pos : b * SEQ + pos - NMETA; }
__device__ __forceinline__ void scan2(float v0, float v1, int lane, float& a0, float& a1) {
    const float s = v0 + v1; float incl = s;
#pragma unroll
    for (int d = 1; d < 64; d <<= 1) { const float t = __shfl_up(incl, d); if (lane >= d) incl += t; }
    a0 = (incl - s) + v0; a1 = a0 + v1;
}
template <int NT>
__device__ __forceinline__ void conv_chunk(const Ctx& C, int col, int xch, int b, int pos0, float (&out)[NT][8]) {
    const bf16* P = WS_BF(C, WS_PROJ);
    v4u raw[NT + 3];
#pragma unroll
    for (int j = 0; j < NT + 3; ++j) { const int pos = pos0 - 3 + j;
        if (pos >= 0) raw[j] = *(const v4u*)(P + (size_t)prow(b, pos) * LDP + col); else raw[j] = (v4u){0u, 0u, 0u, 0u}; }
    float w[4][8], bias[8];
#pragma unroll
    for (int i = 0; i < 4; ++i) { const f32x4 a = *(const f32x4*)(IN_CW(C) + i * D_XBC + xch), c = *(const f32x4*)(IN_CW(C) + i * D_XBC + xch + 4);
        w[i][0] = a.x; w[i][1] = a.y; w[i][2] = a.z; w[i][3] = a.w; w[i][4] = c.x; w[i][5] = c.y; w[i][6] = c.z; w[i][7] = c.w; }
    { const f32x4 a = *(const f32x4*)(IN_CB(C) + xch), c = *(const f32x4*)(IN_CB(C) + xch + 4);
      bias[0] = a.x; bias[1] = a.y; bias[2] = a.z; bias[3] = a.w; bias[4] = c.x; bias[5] = c.y; bias[6] = c.z; bias[7] = c.w; }
#pragma unroll
    for (int k = 0; k < NT; ++k)
#pragma unroll
        for (int e = 0; e < 8; ++e) out[k][e] = bias[e];
#pragma unroll
    for (int j = 0; j < NT + 3; ++j) { float x[8]; unpack8(raw[j], x);
#pragma unroll
        for (int k = 0; k < NT; ++k) { const int i = j - k;
            if (i >= 0 && i < 4) {
#pragma unroll
                for (int e = 0; e < 8; ++e) out[k][e] += w[i][e] * x[e]; } } }
#pragma unroll
    for (int k = 0; k < NT; ++k)
#pragma unroll
        for (int e = 0; e < 8; ++e) out[k][e] = silu_f(out[k][e]);
}

__device__ __forceinline__ void sconv_rows(const Ctx& C, int gw, int ngw) {
    const int lane = C.lane, c0 = 8 * lane;
    const bf16* P = WS_BF(C, WS_PROJ); bf16* A2 = WS_BF(C, WS_A2);
    float w0[8], w1[8], w2[8], nw[8];
    { const float* s = IN_SCW(C);
#pragma unroll
      for (int e = 0; e < 8; ++e) { w0[e] = s[c0 + e]; w1[e] = s[512 + c0 + e]; w2[e] = s[1024 + c0 + e]; nw[e] = IN_SCN(C)[c0 + e]; } }
    for (int r = gw; r < M_MAIN; r += ngw) {
        const bool smp = r >= M_PROMPT; const int t = smp ? ((r - M_PROMPT) & 7) : (r & (SEQ - 1)); const int b = smp ? ((r - M_PROMPT) >> 3) : (r >> 11);
        float gb[8], u0[8], u1[8], u2[8];
        unpack8(*(const v4u*)(P + (size_t)r * LDP + c0), gb);
        unpack8(*(const v4u*)(P + (size_t)r * LDP + PC_U + c0), u0);
        if (!smp) {
            const int r1 = t >= 1 ? r - 1 : ROW_META + 15, r2 = t >= 2 ? r - 2 : (t == 1 ? ROW_META + 15 : ROW_META + 14);
            unpack8(*(const v4u*)(P + (size_t)r1 * LDP + PC_U + c0), u1);
            unpack8(*(const v4u*)(P + (size_t)r2 * LDP + PC_U + c0), u2);
        } else {
            const float* st = IN_SSC(C) + (size_t)b * 2 * 512 + c0;
            if (t >= 1) unpack8(*(const v4u*)(P + (size_t)(r - 1) * LDP + PC_U + c0), u1);
            else { const f32x4 a = *(const f32x4*)(st + 512), c = *(const f32x4*)(st + 512 + 4); u1[0] = a.x; u1[1] = a.y; u1[2] = a.z; u1[3] = a.w; u1[4] = c.x; u1[5] = c.y; u1[6] = c.z; u1[7] = c.w; }
            if (t >= 2) unpack8(*(const v4u*)(P + (size_t)(r - 2) * LDP + PC_U + c0), u2);
            else { const float* s2 = st + (t == 1 ? 512 : 0); const f32x4 a = *(const f32x4*)s2, c = *(const f32x4*)(s2 + 4); u2[0] = a.x; u2[1] = a.y; u2[2] = a.z; u2[3] = a.w; u2[4] = c.x; u2[5] = c.y; u2[6] = c.z; u2[7] = c.w; }
        }
        float v[8], ss = 0.f;
#pragma unroll
        for (int e = 0; e < 8; ++e) { v[e] = gb[e] * (w0[e] * u2[e] + w1[e] * u1[e] + w2[e] * u0[e]); ss += v[e] * v[e]; }
        ss += __shfl_xor(ss, 1); ss += __shfl_xor(ss, 2); ss += __shfl_xor(ss, 4);
        const float rstd = 1.0f / sqrtf(ss * (1.f / 64.f) + EPS);
#pragma unroll
        for (int e = 0; e < 8; ++e) v[e] = v[e] * rstd * nw[e];
        *(v4u*)(A2 + (size_t)r * LDA2 + c0) = pack8(v);
        const int tl = smp ? DSEQ : SEQ;
        if (t >= tl - 2) { float* o = C.out + (smp ? O_SCS : O_SCP) + ((size_t)b * 2 + (t - (tl - 2))) * 512 + c0;
            *(f32x4*)o = (f32x4){u0[0], u0[1], u0[2], u0[3]}; *(f32x4*)(o + 4) = (f32x4){u0[4], u0[5], u0[6], u0[7]}; }
        if (t >= tl - 3) { float* o = C.out + (smp ? O_XCS : O_XCP) + ((size_t)b * 3 + (t - (tl - 3))) * D_XBC;
#pragma unroll
            for (int q = 0; q < 3; ++q) { float x[8]; unpack8(*(const v4u*)(P + (size_t)r * LDP + PC_X + 512 * q + c0), x);
                *(f32x4*)(o + 512 * q + c0) = (f32x4){x[0], x[1], x[2], x[3]}; *(f32x4*)(o + 512 * q + c0 + 4) = (f32x4){x[4], x[5], x[6], x[7]}; } }
    }
}

__device__ __forceinline__ void sample_item(const Ctx& C, int b, int g) {
    const int tid = C.tid, lane = C.lane, w = C.wave, li = lane & 15, g4 = lane >> 4;
    LAS float* xc = (LAS float*)(C.lds + RING_OFF);
    LAS float* Bc = xc + 4096;
    LAS float* Cc = Bc + 1024;
    LAS float* dtv = Cc + 1024;
    LAS float* acv = dtv + 64;
    LAS float* Gm = acv + 64;
    LAS float* ssw = Gm + 64;
    const bf16* P = WS_BF(C, WS_PROJ); const int rowb = M_PROMPT + 8 * b;
    __syncthreads();
    if (tid < 384) {
        const int ch = 2 * tid; int pcol, xch, stride; LAS float* dst;
        if (ch < 512) { pcol = PC_X + g * 512 + ch; xch = g * 512 + ch; dst = xc + ch; stride = 512; }
        else if (ch < 640) { const int j = ch - 512; pcol = PC_B + g * 128 + j; xch = 1024 + g * 128 + j; dst = Bc + j; stride = 128; }
        else { const int j = ch - 640; pcol = PC_C + g * 128 + j; xch = 1280 + g * 128 + j; dst = Cc + j; stride = 128; }
        float i0[11], i1[11];
#pragma unroll
        for (int j = 0; j < 3; ++j) { const f32x2 hv = *(const f32x2*)(IN_SXC(C) + ((size_t)b * 3 + j) * D_XBC + xch); i0[j] = hv.x; i1[j] = hv.y; }
#pragma unroll
        for (int t = 0; t < 8; ++t) { const unsigned raw = *(const unsigned*)(P + (size_t)(rowb + t) * LDP + pcol); i0[3 + t] = bflo(raw); i1[3 + t] = bfhi(raw); }
        float wa[4], wb[4];
#pragma unroll
        for (int i = 0; i < 4; ++i) { const f32x2 wv = *(const f32x2*)(IN_CW(C) + i * D_XBC + xch); wa[i] = wv.x; wb[i] = wv.y; }
        const f32x2 bv = *(const f32x2*)(IN_CB(C) + xch);
#pragma unroll
        for (int t = 0; t < 8; ++t) { float a = bv.x, c = bv.y;
#pragma unroll
            for (int i = 0; i < 4; ++i) { a += wa[i] * i0[t + i]; c += wb[i] * i1[t + i]; }
            dst[t * stride] = silu_f(a); dst[t * stride + 1] = silu_f(c); }
    } else if (tid < 392) {
        const int hh = tid - 384, h = g * 8 + hh; const float Ah = -__expf(IN_ALOG(C)[h]), bh = IN_DTB(C)[h]; float acc = 0.f;
        for (int t = 0; t < 8; ++t) { const float d = softplus_f(WS_F32(C, WS_DT)[(size_t)(rowb + t) * 16 + h] + bh); acc += d * Ah; dtv[t * 8 + hh] = d; acv[t * 8 + hh] = acc; }
    }
    __syncthreads();
    { const int pair = tid >> 3, part = tid & 7, t = pair >> 3, s = pair & 7; float sum = 0.f;
#pragma unroll
      for (int n = 0; n < 16; ++n) sum += Cc[t * 128 + part * 16 + n] * Bc[s * 128 + part * 16 + n];
      sum += __shfl_xor(sum, 1); sum += __shfl_xor(sum, 2); sum += __shfl_xor(sum, 4);
      if (part == 0) Gm[pair] = sum; }
    __syncthreads();
    const int hh = w, h = g * 8 + hh;
    const float* s0p = IN_SSM(C) + (size_t)(b * 16 + h) * 8192; float* s1p = C.out + O_SSS + (size_t)(b * 16 + h) * 8192;
    const int tr = li & 7;
    const float a7 = acv[56 + hh];
    bf16x8 A2f, B2f[4];
    { float gd[8];
#pragma unroll
      for (int s = 0; s < 8; ++s) gd[s] = (li < 8 && g4 == 0 && s <= li) ? Gm[tr * 8 + s] * __expf(acv[tr * 8 + hh] - acv[s * 8 + hh]) * dtv[s * 8 + hh] : 0.f;
      A2f = __builtin_bit_cast(bf16x8, pack8(gd)); }
#pragma unroll
    for (int pt = 0; pt < 4; ++pt) { float xv[8];
#pragma unroll
        for (int s = 0; s < 8; ++s) xv[s] = g4 == 0 ? xc[s * 512 + hh * 64 + 16 * pt + li] : 0.f;
        B2f[pt] = __builtin_bit_cast(bf16x8, pack8(xv)); }
    f32x4 accY[4];
#pragma unroll
    for (int pt = 0; pt < 4; ++pt) accY[pt] = MFMA16(A2f, B2f[pt], ((f32x4){0.f, 0.f, 0.f, 0.f}));
    const float ea = li < 8 ? __expf(acv[tr * 8 + hh]) : 0.f;
    const float e7 = __expf(a7);
#pragma unroll 1
    for (int i = 0; i < 4; ++i) {
        f32x4 v[4][2];
#pragma unroll
        for (int pt = 0; pt < 4; ++pt)
#pragma unroll
            for (int q = 0; q < 2; ++q) v[pt][q] = *(const f32x4*)(s0p + (size_t)(16 * pt + li) * 128 + 32 * i + 16 * q + 4 * g4);
        const f32x4 c0 = *(const LAS f32x4*)(Cc + tr * 128 + 32 * i + 4 * g4) * ea, c1 = *(const LAS f32x4*)(Cc + tr * 128 + 32 * i + 16 + 4 * g4) * ea;
        const bf16x8 af = pack8v(c0, c1);
#pragma unroll
        for (int pt = 0; pt < 4; ++pt) accY[pt] = MFMA16(af, pack8v(v[pt][0], v[pt][1]), accY[pt]);
#pragma unroll
        for (int q = 0; q < 2; ++q) { float bvv[8];
#pragma unroll
            for (int t = 0; t < 8; ++t) bvv[t] = g4 == 0 ? Bc[t * 128 + 32 * i + 16 * q + li] * __expf(a7 - acv[t * 8 + hh]) * dtv[t * 8 + hh] : 0.f;
            const bf16x8 a3 = __builtin_bit_cast(bf16x8, pack8(bvv));
#pragma unroll
            for (int pt = 0; pt < 4; ++pt) { const f32x4 r = MFMA16(a3, B2f[pt], v[pt][q] * e7);
                *(f32x4*)(s1p + (size_t)(16 * pt + li) * 128 + 32 * i + 16 * q + 4 * g4) = r; } }
    }
    const float Dh = IN_DSK(C)[h]; float yv[4][4], sq[4] = {0.f, 0.f, 0.f, 0.f};
#pragma unroll
    for (int pt = 0; pt < 4; ++pt)
#pragma unroll
        for (int r = 0; r < 4; ++r) { const int t = (4 * g4 + r) & 7;
            const float z = bflo((unsigned)P[(size_t)(rowb + t) * LDP + PC_Z + h * 64 + 16 * pt + li]);
            const float y = (accY[pt][r] + Dh * xc[t * 512 + hh * 64 + 16 * pt + li]) * silu_f(z); yv[pt][r] = y; sq[r] += y * y; }
#pragma unroll
    for (int r = 0; r < 4; ++r) { float s = sq[r]; s += __shfl_xor(s, 1); s += __shfl_xor(s, 2); s += __shfl_xor(s, 4); s += __shfl_xor(s, 8);
        if (li == 0 && g4 < 2) ssw[hh * 8 + 4 * g4 + r] = s; }
    __syncthreads();
    if (g4 < 2) {
        bf16* A2 = WS_BF(C, WS_A2);
#pragma unroll
        for (int r = 0; r < 4; ++r) { const int t = 4 * g4 + r; float tot = 0.f;
#pragma unroll
            for (int k = 0; k < 8; ++k) tot += ssw[k * 8 + t];
            const float rstd = 1.0f / sqrtf(tot * (1.f / 512.f) + EPS);
#pragma unroll
            for (int pt = 0; pt < 4; ++pt) { const int ch = h * 64 + 16 * pt + li;
                A2[(size_t)(rowb + t) * LDA2 + 512 + ch] = (bf16)(pkbf(yv[pt][r] * rstd * IN_SSN(C)[ch], 0.f) & 0xffffu); } }
    }
}

__device__ __forceinline__ void pass_s_unit(const Ctx& C, int b, int h) {
    const int tid = C.tid, lane = C.lane, w = C.wave, li = lane & 15, g4 = lane >> 4, g = h >> 3;
    LAS unsigned char* Bt = C.lds + RING_OFF; LAS unsigned char* Xt = C.lds + RING_OFF + 32768;
    LAS float* dtl = (LAS float*)(C.lds + EXTRA_OFF); LAS float* acl = dtl + 128;
    const float Ah = -__expf(IN_ALOG(C)[h]), bh = IN_DTB(C)[h];
    const float* DT = WS_F32(C, WS_DT); bf16* SP = WS_BF(C, WS_SPREV);
    f32x4 acc[4];
#pragma unroll
    for (int pt = 0; pt < 4; ++pt) acc[pt] = (f32x4){0.f, 0.f, 0.f, 0.f};
#pragma unroll 1
    for (int ci = -1; ci < 16; ++ci) {
        const int ntok = ci < 0 ? 16 : 128, pos0 = ci < 0 ? 0 : NMETA + 128 * ci, kpad = ci < 0 ? 32 : 128;
        if (w == 0) {
            const int l0 = 2 * lane; float d0 = 0.f, d1 = 0.f;
            if (l0 < ntok) { d0 = softplus_f(DT[(size_t)prow(b, pos0 + l0) * 16 + h] + bh); d1 = softplus_f(DT[(size_t)prow(b, pos0 + l0 + 1) * 16 + h] + bh); }
            float a0, a1; scan2(d0 * Ah, d1 * Ah, lane, a0, a1);
            dtl[l0] = d0; dtl[l0 + 1] = d1; acl[l0] = a0; acl[l0 + 1] = a1;
        }
        __syncthreads();
        const float a_end = acl[ntok - 1];
        { const int ch = tid & 15, l0 = 4 * (tid >> 4);
          if (l0 < kpad) {
              if (l0 < ntok) { float o[4][8]; conv_chunk<4>(C, PC_B + g * 128 + 8 * ch, 1024 + g * 128 + 8 * ch, b, pos0 + l0, o);
#pragma unroll
                  for (int k = 0; k < 4; ++k) *(LAS v4u*)(Bt + off_b(l0 + k, ch)) = pack8(o[k]); }
              else {
#pragma unroll
                  for (int k = 0; k < 4; ++k) *(LAS v4u*)(Bt + off_b(l0 + k, ch)) = (v4u){0u, 0u, 0u, 0u}; } } }
        { const int ch = tid & 7, l0 = 2 * (tid >> 3);
          if (l0 < kpad) {
              if (l0 < ntok) { float o[2][8]; conv_chunk<2>(C, PC_X + h * 64 + 8 * ch, h * 64 + 8 * ch, b, pos0 + l0, o);
#pragma unroll
                  for (int k = 0; k < 2; ++k) { const float sc = dtl[l0 + k] * __expf(a_end - acl[l0 + k]);
#pragma unroll
                      for (int e = 0; e < 8; ++e) o[k][e] *= sc;
                      *(LAS v4u*)(Xt + off_b(l0 + k, ch)) = pack8(o[k]); } }
              else {
#pragma unroll
                  for (int k = 0; k < 2; ++k) *(LAS v4u*)(Xt + off_b(l0 + k, ch)) = (v4u){0u, 0u, 0u, 0u}; } } }
        __syncthreads();
        if (ci >= 0) {
            const float ed = __expf(a_end);
#pragma unroll
            for (int pt = 0; pt < 4; ++pt) { v2u o; o.x = pkbf(acc[pt][0], acc[pt][1]); o.y = pkbf(acc[pt][2], acc[pt][3]);
                *(v2u*)(SP + ((((size_t)(b * 16 + h) * 16 + ci) * 64 + 16 * pt + li) * 128 + 16 * w + 4 * g4)) = o;
                acc[pt] = acc[pt] * ed; }
        }
        const int nks = kpad >> 5;
        for (int ks = 0; ks < nks; ++ks) {
            const bf16x8 a = cat4(tr_read(Bt + tr_read_addr_16(lane, w, ks, 0)), tr_read(Bt + tr_read_addr_16(lane, w, ks, 1)));
#pragma unroll
            for (int pt = 0; pt < 4; ++pt) { const bf16x8 bb = cat4(tr_read(Xt + tr_read_addr_16(lane, pt, ks, 0)), tr_read(Xt + tr_read_addr_16(lane, pt, ks, 1)));
                acc[pt] = MFMA16(a, bb, acc[pt]); }
        }
    }
    float* o = C.out + O_SSP + (size_t)(b * 16 + h) * 8192;
#pragma unroll
    for (int pt = 0; pt < 4; ++pt) *(f32x4*)(o + (size_t)(16 * pt + li) * 128 + 16 * w + 4 * g4) = acc[pt];
    __syncthreads();
}

__device__ __forceinline__ void pass_y_unit(const Ctx& C, int b, int g, int c) {
    const int tid = C.tid, lane = C.lane, w = C.wave, li = lane & 15, g4 = lane >> 4;
    LAS unsigned char* Bt = C.lds + RING_OFF; LAS unsigned char* Ct = C.lds + RING_OFF + 32768; LAS unsigned char* Xt = C.lds + RING_OFF + 65536;
    LAS float* dtT = (LAS float*)(C.lds + EXTRA_OFF); LAS float* acT = dtT + 1024;
    const int row0 = b * SEQ + 128 * c, pos0 = NMETA + 128 * c;
    const bf16* P = WS_BF(C, WS_PROJ); bf16* A2 = WS_BF(C, WS_A2); const bf16* SP = WS_BF(C, WS_SPREV);
    __syncthreads();
    { const int h = g * 8 + w; const float Ah = -__expf(IN_ALOG(C)[h]), bh = IN_DTB(C)[h]; const int l0 = 2 * lane;
      const float d0 = softplus_f(WS_F32(C, WS_DT)[(size_t)(row0 + l0) * 16 + h] + bh), d1 = softplus_f(WS_F32(C, WS_DT)[(size_t)(row0 + l0 + 1) * 16 + h] + bh);
      float a0, a1; scan2(d0 * Ah, d1 * Ah, lane, a0, a1);
      dtT[w * 128 + l0] = d0; dtT[w * 128 + l0 + 1] = d1; acT[w * 128 + l0] = a0; acT[w * 128 + l0 + 1] = a1; }
    { const int ch = tid & 15, l0 = 4 * (tid >> 4); float o[4][8];
      conv_chunk<4>(C, PC_B + g * 128 + 8 * ch, 1024 + g * 128 + 8 * ch, b, pos0 + l0, o);
#pragma unroll
      for (int k = 0; k < 4; ++k) *(LAS v4u*)(Bt + off_b(l0 + k, ch)) = pack8(o[k]);
      conv_chunk<4>(C, PC_C + g * 128 + 8 * ch, 1280 + g * 128 + 8 * ch, b, pos0 + l0, o);
#pragma unroll
      for (int k = 0; k < 4; ++k) *(LAS v4u*)(Ct + off_b(l0 + k, ch)) = pack8(o[k]); }
    __syncthreads();
    bf16x8 Cf[4];
#pragma unroll
    for (int ks = 0; ks < 4; ++ks) Cf[ks] = *(const LAS bf16x8*)(Ct + row_read_addr_16(lane, w, ks));
    f32x4 accS[8];
#pragma unroll
    for (int st = 0; st < 8; ++st) { accS[st] = (f32x4){0.f, 0.f, 0.f, 0.f};
        if (st <= w) {
#pragma unroll
            for (int ks = 0; ks < 4; ++ks) accS[st] = MFMA16(*(const LAS bf16x8*)(Bt + row_read_addr_16(lane, st, ks)), Cf[ks], accS[st]); } }
    float ssq = 0.f;
    const int lrow = row0 + 16 * w + li;
#pragma unroll 1
    for (int hp = 0; hp < 4; ++hp) {
        __syncthreads();
        { const int ch = tid & 15, l0 = 4 * (tid >> 4); float o[4][8];
          conv_chunk<4>(C, PC_X + (g * 8 + 2 * hp) * 64 + 8 * ch, (g * 8 + 2 * hp) * 64 + 8 * ch, b, pos0 + l0, o);
#pragma unroll
          for (int k = 0; k < 4; ++k) *(LAS v4u*)(Xt + off_b(l0 + k, ch)) = pack8(o[k]); }
        __syncthreads();
#pragma unroll 1
        for (int hh2 = 0; hh2 < 2; ++hh2) {
            const int hh = 2 * hp + hh2, h = g * 8 + hh;
            const float a_l = acT[hh * 128 + 16 * w + li];
            bf16x8 Pf[4];
#pragma unroll
            for (int i = 0; i < 4; ++i) {
                Pf[i] = (bf16x8){0, 0, 0, 0, 0, 0, 0, 0};
                if (2 * i <= w) {
                    const f32x4 as0 = *(const LAS f32x4*)(acT + hh * 128 + 32 * i + 4 * g4), ds0 = *(const LAS f32x4*)(dtT + hh * 128 + 32 * i + 4 * g4);
                    const f32x4 as1 = *(const LAS f32x4*)(acT + hh * 128 + 32 * i + 16 + 4 * g4), ds1 = *(const LAS f32x4*)(dtT + hh * 128 + 32 * i + 16 + 4 * g4);
                    f32x4 v0, v1;
#pragma unroll
                    for (int r = 0; r < 4; ++r) {
                        const float x0 = accS[2 * i][r] * __expf(a_l - as0[r]) * ds0[r];
                        v0[r] = (2 * i == w && 4 * g4 + r > li) ? 0.f : x0;
                        const float x1 = accS[2 * i + 1][r] * __expf(a_l - as1[r]) * ds1[r];
                        v1[r] = (2 * i + 1 > w || (2 * i + 1 == w && 4 * g4 + r > li)) ? 0.f : x1; }
                    Pf[i] = pack8v(v0, v1);
                }
            }
            f32x4 acc[4], accO[4];
#pragma unroll
            for (int pt = 0; pt < 4; ++pt) { acc[pt] = (f32x4){0.f, 0.f, 0.f, 0.f}; accO[pt] = (f32x4){0.f, 0.f, 0.f, 0.f}; }
#pragma unroll
            for (int i = 0; i < 4; ++i) {
                if (2 * i <= w) {
#pragma unroll
                    for (int pt = 0; pt < 4; ++pt) { const bf16x8 xa = cat4(tr_read(Xt + tr_read_addr_perm(lane, 4 * hh2 + pt, i, 0)), tr_read(Xt + tr_read_addr_perm(lane, 4 * hh2 + pt, i, 1)));
                        acc[pt] = MFMA16(xa, Pf[i], acc[pt]); }
                }
            }
            const bf16* sp = SP + (((size_t)(b * 16 + h) * 16 + c) * 64) * 128;
#pragma unroll
            for (int ks = 0; ks < 4; ++ks)
#pragma unroll
                for (int pt = 0; pt < 4; ++pt) accO[pt] = MFMA16(*(const bf16x8*)(sp + (size_t)(16 * pt + li) * 128 + 32 * ks + 8 * g4), Cf[ks], accO[pt]);
            const float ea = __expf(a_l), Dh = IN_DSK(C)[h];
#pragma unroll
            for (int pt = 0; pt < 4; ++pt) { const int p0 = 16 * pt + 4 * g4;
                const v2u xr = *(const LAS v2u*)(Xt + off_b(16 * w + li, 8 * hh2 + 2 * pt + (g4 >> 1)) + 8 * (g4 & 1));
                const v2u zr = *(const v2u*)(P + (size_t)lrow * LDP + PC_Z + h * 64 + p0);
                const float xv[4] = {bflo(xr.x), bfhi(xr.x), bflo(xr.y), bfhi(xr.y)}, zv[4] = {bflo(zr.x), bfhi(zr.x), bflo(zr.y), bfhi(zr.y)};
                float y[4];
#pragma unroll
                for (int r = 0; r < 4; ++r) { y[r] = (acc[pt][r] + ea * accO[pt][r] + Dh * xv[r]) * silu_f(zv[r]); ssq += y[r] * y[r]; }
                v2u o; o.x = pkbf(y[0], y[1]); o.y = pkbf(y[2], y[3]);
                *(v2u*)(A2 + (size_t)lrow * LDA2 + 512 + h * 64 + p0) = o; }
        }
    }
    ssq += __shfl_xor(ssq, 16); ssq += __shfl_xor(ssq, 32);
    const float rstd = 1.0f / sqrtf(ssq * (1.f / 512.f) + EPS);
#pragma unroll 1
    for (int hh = 0; hh < 8; ++hh)
#pragma unroll
        for (int pt = 0; pt < 4; ++pt) { const int ch = (g * 8 + hh) * 64 + 16 * pt + 4 * g4; bf16* q = A2 + (size_t)lrow * LDA2 + 512 + ch;
            const v2u yr = *(const v2u*)q; const f32x4 nw = *(const f32x4*)(IN_SSN(C) + ch);
            v2u o; o.x = pkbf(bflo(yr.x) * rstd * nw.x, bfhi(yr.x) * rstd * nw.y); o.y = pkbf(bflo(yr.y) * rstd * nw.z, bfhi(yr.y) * rstd * nw.w);
            *(v2u*)q = o; }
}
__device__ __forceinline__ void p2a_phase(const Ctx& C) {
    const int bx = blockIdx.x, nE = (C.G + 1) >> 1, nO = C.G >> 1;
    if ((bx & 1) == 0) {
        for (int u = bx >> 1; u < NBATCH * NHEAD; u += nE) pass_s_unit(C, u >> 4, u & 15);
    } else {
        const int sb = bx >> 1;
        for (int it = sb; it < DBATCH * 2; it += nO) sample_item(C, it >> 1, it & 1);
        sconv_rows(C, sb * NWAVES + C.wave, nO * NWAVES);
    }
}
__device__ __forceinline__ void p2b_phase(const Ctx& C) {
    for (int u = blockIdx.x; u < NBATCH * 2 * 16; u += C.G) pass_y_unit(C, u >> 5, (u >> 4) & 1, u & 15);
}

constexpr int NPHASE = 9;
struct Args { const float* in[23]; float* out; unsigned char* ws; int ph_lo, ph_hi; };
__global__ void __launch_bounds__(NWAVES * 64, 2) hymba_fwd(Args args) {
    extern __shared__ __attribute__((aligned(16))) unsigned char lds[];
    Ctx C;
    C.lds = (LAS unsigned char*)lds;
    C.tid = threadIdx.x; C.lane = C.tid & 63; C.wave = __builtin_amdgcn_readfirstlane(C.tid >> 6);
    C.G = gridDim.x;
#pragma unroll
    for (int i = 0; i < 23; ++i) C.in[i] = args.in[i];
    C.out = args.out; C.ws = args.ws; C.ctl = (gu32*)(args.ws + WS_CTL);
    for (int u = C.tid; u < (LDS_BYTES - LDSCTL_OFF) / 4; u += NWAVES * 64) ((LAS unsigned*)(C.lds + LDSCTL_OFF))[u] = 0u;
    __syncthreads();
    XcdBarrier bar; bar.bar = (unsigned*)(C.ctl + CW_BAR); bar.x = 0; bar.st = nullptr;
    if (!MK_SPLIT) bar = xcd_barrier_post((unsigned*)(C.ctl + CW_BAR), (volatile LAS unsigned*)(C.lds + MISC_OFF) + 8);
    const int lo = args.ph_lo, hi = args.ph_hi;
#define IN(k) (lo <= (k) && (k) < hi)
#define SEAM(k) do { if (IN(k) && IN((k) + 1)) xcd_barrier(bar); } while (0)
    if (IN(0)) { p0_prologue(C); } SEAM(0);
    if (IN(1)) {
        pg8::Gemm g{WS_BF(C, WS_XN), WS_BF(C, WS_WIN), M_G1, N_G1, DM}; pg8::StaticOrder S; S.init(M_G1, N_G1, C.G, (int)blockIdx.x);
        pg8::EpiProj E{WS_BF(C, WS_PROJ), WS_F32(C, WS_DT), LDP};
        pg8::gemm_phase<pg8::EpiProj, pg8::StaticOrder, PG8_ALIGN, PG8_SP2>(C.lds + RING_OFF, g, S, E);
    } SEAM(1);
    if (IN(2)) { p2a_phase(C); } SEAM(2);
    if (IN(3)) { p2b_phase(C); } SEAM(3);
    if (IN(4)) {
        pg8::Gemm g{WS_BF(C, WS_A2), WS_BF(C, WS_WOUT), M_MAIN, DM, 1536}; pg8::StaticOrder S; S.init(M_MAIN, DM, C.G, (int)blockIdx.x);
        pg8::EpiF32 E{WS_F32(C, WS_MIX), DM};
        pg8::gemm_phase<pg8::EpiF32, pg8::StaticOrder, PG8_ALIGN, PG8_SP2>(C.lds + RING_OFF, g, S, E);
    } SEAM(4);
    if (IN(5)) { norm1_phase(C); } SEAM(5);
    if (IN(6)) {
        pg8::Gemm g{WS_BF(C, WS_XN), WS_BF(C, WS_WGU), M_MAIN, 2 * D_FF, DM}; pg8::StaticOrder S; S.init(M_MAIN, 2 * D_FF, C.G, (int)blockIdx.x);
        pg8::EpiSwiGLU E{WS_BF(C, WS_ACT), D_FF};
        pg8::gemm_phase<pg8::EpiSwiGLU, pg8::StaticOrder, PG8_ALIGN, PG8_SP2>(C.lds + RING_OFF, g, S, E);
    } SEAM(6);
    if (IN(7)) {
        pg8::Gemm g{WS_BF(C, WS_ACT), WS_BF(C, WS_WDOWN), M_MAIN, DM, D_FF}; pg8::StaticOrder S; S.init(M_MAIN, DM, C.G, (int)blockIdx.x);
        pg8::EpiF32 E{WS_F32(C, WS_F), DM};
        pg8::gemm_phase<pg8::EpiF32, pg8::StaticOrder, PG8_ALIGN, PG8_SP2>(C.lds + RING_OFF, g, S, E);
    } SEAM(7);
    if (IN(8)) { norm2_phase(C); }
#undef IN
#undef SEAM
}

extern "C" void kernel_launch(void* const* d_in, const int* in_sizes, int n_in, void* d_out, int out_size, void* d_ws, size_t ws_size, hipStream_t stream) {
    static int grid = 0;
    if (grid == 0) {
        if (n_in != 23 || in_sizes[0] != M_PROMPT * DM || (size_t)out_size != O_END || ws_size < WS_END) {
            fprintf(stderr, "kernel_launch: unexpected problem shape (n_in %d, in0 %d, out %d, ws %zu); nothing launched\n", n_in, n_in > 0 ? in_sizes[0] : -1, out_size, ws_size); grid = -1; return; }
        int dev = 0, cus = 0, per_cu = 0;
        if (hipGetDevice(&dev) != hipSuccess || hipDeviceGetAttribute(&cus, hipDeviceAttributeMultiprocessorCount, dev) != hipSuccess) { grid = -1; return; }
        if (hipFuncSetAttribute((const void*)hymba_fwd, hipFuncAttributeMaxDynamicSharedMemorySize, LDS_BYTES) != hipSuccess) { fprintf(stderr, "kernel_launch: hipFuncSetAttribute failed\n"); grid = -1; return; }
        if (hipOccupancyMaxActiveBlocksPerMultiprocessor(&per_cu, (const void*)hymba_fwd, NWAVES * 64, LDS_BYTES) != hipSuccess || per_cu < 1) {
            fprintf(stderr, "kernel_launch: occupancy query reports %d workgroups per CU; nothing launched\n", per_cu); (void)hipGetLastError(); grid = -1; return; }
        grid = cus;
    }
    if (grid < 0) return;
    if (hipMemsetAsync((char*)d_ws + WS_CTL, 0, CTL_ZERO_BYTES, stream) != hipSuccess) return;
    Args a{};
    for (int i = 0; i < 23; ++i) a.in[i] = (const float*)d_in[i];
    a.out = (float*)d_out; a.ws = (unsigned char*)d_ws;
#if MK_SPLIT
    for (int p = 0; p < NPHASE; ++p) { a.ph_lo = p; a.ph_hi = p + 1; hipLaunchKernelGGL(hymba_fwd, dim3(grid), dim3(NWAVES * 64), LDS_BYTES, stream, a); }
#else
    a.ph_lo = 0; a.ph_hi = NPHASE;
    hipLaunchKernelGGL(hymba_fwd, dim3(grid), dim3(NWAVES * 64), LDS_BYTES, stream, a);
#endif
}
```
